# Optimizing an MI355X kernel written in HIP

```python
import math
import jax, jax.numpy as jnp
from jax import lax
import numpy as np

D_MODEL = 1024
BATCH = 8
SEQ = 4096
DEPTH = 1
DEC_BATCH = 32
DEC_SEQ = 64
PAST_LEN = 4096

CHUNK = 64
SSM_EXPAND = 2
D_INNER = SSM_EXPAND * D_MODEL
SSM_HEAD_DIM = 64
SSM_HEADS = D_INNER // SSM_HEAD_DIM
N_GROUPS = 4
HEADS_PER_GROUP = SSM_HEADS // N_GROUPS
D_STATE = 128
CONV_W = 4
CONV_DIM = D_INNER + 2 * N_GROUPS * D_STATE
SSD_CHUNK = 64
ATT_HEADS = 16
ATT_HEAD_DIM = 64
D_ATT = ATT_HEADS * ATT_HEAD_DIM
LEFT_CHUNKS = 8
ATT_WINDOW = LEFT_CHUNKS * CHUNK
BAND = ATT_WINDOW + CHUNK
REL_CLIP = 256
SPLIT_SIZES = (D_INNER, CONV_DIM, SSM_HEADS, D_ATT, D_ATT, D_ATT, D_ATT, D_MODEL, D_MODEL)
D_IN_PROJ = sum(SPLIT_SIZES)
NORM_EPS = 1e-5
NEG_INF = -1e30

kernel_name = 'hybrid_ssd_chunkband_attn_stream_step'


def rmsnorm(x, w):
    xf = x.astype(jnp.float32)
    xf = xf * lax.rsqrt(jnp.mean(xf * xf, axis=-1, keepdims=True) + NORM_EPS)
    return xf.astype(x.dtype) * w


def split_projection(x, norm_w, w_in):
    xn = rmsnorm(x, norm_w)
    proj = jnp.einsum('bld,de->ble', xn, w_in)
    points, acc = [], 0
    for s in SPLIT_SIZES[:-1]:
        acc += s
        points.append(acc)
    return jnp.split(proj, points, axis=-1)


def causal_conv(u, buf, conv_w, conv_b):
    L = u.shape[1]
    up = jnp.concatenate([buf.astype(u.dtype), u], axis=1)
    y = conv_b
    for j in range(CONV_W):
        y = y + conv_w[j] * up[:, j:j + L]
    return jax.nn.silu(y), up[:, -(CONV_W - 1):]


def ssd_scan(xdt, adt, bm, cm, h0):
    b, L = xdt.shape[:2]
    n_chunks = -(-L // SSD_CHUNK)
    pad = n_chunks * SSD_CHUNK - L

    def blocks(t):
        t = jnp.pad(t, [(0, 0), (0, pad)] + [(0, 0)] * (t.ndim - 2))
        t = t.reshape((b, n_chunks, SSD_CHUNK) + t.shape[2:])
        return jnp.moveaxis(t, 1, 0)

    tri = jnp.tril(jnp.ones((SSD_CHUNK, SSD_CHUNK), bool))[None, :, :, None, None]

    def step(h, inp):
        xc, ac, bc, cc = inp
        acs = jnp.cumsum(ac, axis=1)
        seg = acs[:, :, None] - acs[:, None, :]
        decay = jnp.exp(jnp.where(tri, seg, -jnp.inf))
        cb = jnp.einsum('blgn,bsgn->blsg', cc, bc)
        y_diag = jnp.einsum('blsgr,bsgrp->blgrp', cb[..., None] * decay, xc)
        y_off = jnp.einsum('blgn,bgrpn->blgrp', cc, h) * jnp.exp(acs)[..., None]
        to_end = jnp.exp(acs[:, -1:] - acs)
        h_new = h * jnp.exp(acs[:, -1])[..., None, None] + jnp.einsum(
            'blgn,blgrp->bgrpn', bc, xc * to_end[..., None])
        return h_new, y_diag + y_off

    h_final, ys = lax.scan(step, h0, (blocks(xdt), blocks(adt), blocks(bm), blocks(cm)))
    ys = jnp.moveaxis(ys, 0, 1).reshape((b, n_chunks * SSD_CHUNK) + ys.shape[3:])[:, :L]
    return ys, h_final


def ssm_branch(z, xbc, dt_raw, conv_buf, h0, conv_w, conv_b, dt_bias, a_log, d_skip,
               ssm_norm_w, w_out_ssm):
    b, L, _ = z.shape
    f32 = jnp.float32
    xbc_c, new_buf = causal_conv(xbc, conv_buf, conv_w, conv_b)
    xs, bm, cm = jnp.split(xbc_c, [D_INNER, D_INNER + N_GROUPS * D_STATE], axis=-1)
    xs = xs.astype(f32).reshape(b, L, N_GROUPS, HEADS_PER_GROUP, SSM_HEAD_DIM)
    bm = bm.astype(f32).reshape(b, L, N_GROUPS, D_STATE)
    cm = cm.astype(f32).reshape(b, L, N_GROUPS, D_STATE)
    dt = jax.nn.softplus((dt_raw + dt_bias).astype(f32)).reshape(b, L, N_GROUPS, HEADS_PER_GROUP)
    a = -jnp.exp(a_log.astype(f32)).reshape(N_GROUPS, HEADS_PER_GROUP)
    h0 = h0.astype(f32).reshape(b, N_GROUPS, HEADS_PER_GROUP, SSM_HEAD_DIM, D_STATE)
    y, h_final = ssd_scan(xs * dt[..., None], dt * a, bm, cm, h0)
    y = y + d_skip.astype(f32).reshape(N_GROUPS, HEADS_PER_GROUP)[:, :, None] * xs
    yz = y.reshape(b, L, D_INNER) * jax.nn.silu(z.astype(f32))
    yz = yz.reshape(b, L, N_GROUPS, D_INNER // N_GROUPS)
    yz = yz * lax.rsqrt(jnp.mean(yz * yz, axis=-1, keepdims=True) + NORM_EPS)
    yz = yz.reshape(b, L, D_INNER).astype(z.dtype) * ssm_norm_w
    y_out = jnp.einsum('bld,de->ble', yz, w_out_ssm)
    h_final = h_final.reshape(b, SSM_HEADS, SSM_HEAD_DIM, D_STATE).astype(z.dtype)
    return y_out, new_buf, h_final


def rel_bias_matrix(rel_bias, n_q, n_k, offset):
    d = offset + jnp.arange(n_q)[:, None] - jnp.arange(n_k)[None, :]
    idx = jnp.clip(d, -REL_CLIP, REL_CLIP) + REL_CLIP
    return rel_bias[:, idx].astype(jnp.float32)


def band_attention(q, k, v, bias, valid):
    s = jnp.einsum('bthd,bshd->bhts', q, k, preferred_element_type=jnp.float32)
    s = s * (ATT_HEAD_DIM ** -0.5) + bias
    if valid is not None:
        s = jnp.where(valid, s, NEG_INF)
    p = jax.nn.softmax(s, axis=-1)
    return jnp.einsum('bhts,bshd->bthd', p.astype(v.dtype), v)


def chunk_band_attention_prompt(q, k, v, rel_bias):
    b, L = q.shape[:2]
    n_chunks = L // CHUNK
    kp = jnp.pad(k, ((0, 0), (ATT_WINDOW, 0), (0, 0), (0, 0)))
    vp = jnp.pad(v, ((0, 0), (ATT_WINDOW, 0), (0, 0), (0, 0)))
    bias = rel_bias_matrix(rel_bias, CHUNK, BAND, ATT_WINDOW)
    j_idx = jnp.arange(BAND)

    def one_chunk(c):
        start = c * CHUNK
        qc = lax.dynamic_slice_in_dim(q, start, CHUNK, axis=1)
        kc = lax.dynamic_slice_in_dim(kp, start, BAND, axis=1)
        vc = lax.dynamic_slice_in_dim(vp, start, BAND, axis=1)
        valid = (start - ATT_WINDOW + j_idx >= 0)[None, :]
        return band_attention(qc, kc, vc, bias, valid)

    o = lax.map(one_chunk, jnp.arange(n_chunks))
    o = jnp.moveaxis(o, 0, 1).reshape(b, L, D_ATT)
    keep = min(ATT_WINDOW, L)
    return o, k[:, -keep:], v[:, -keep:]


def chunk_band_attention_step(q, k, v, k_past, v_past, rel_bias):
    b, T = q.shape[:2]
    w = k_past.shape[1]
    kk = jnp.concatenate([k_past.astype(k.dtype), k], axis=1)
    vv = jnp.concatenate([v_past.astype(v.dtype), v], axis=1)
    bias = rel_bias_matrix(rel_bias, T, w + T, w)
    o = band_attention(q, kk, vv, bias, None).reshape(b, T, D_ATT)
    return o, kk[:, -w:], vv[:, -w:]


def hybrid_layer(x, h0, conv_buf, k_past, v_past, norm_w, w_in, conv_w, conv_b, dt_bias,
                 a_log, d_skip, ssm_norm_w, w_out_ssm, rel_bias, w_out_att, w_o):
    b, L, _ = x.shape
    z, xbc, dt_raw, q, k, v, g_att, gate_ssm, gate_att = split_projection(x, norm_w, w_in)
    y_ssm, new_conv, new_h = ssm_branch(z, xbc, dt_raw, conv_buf, h0, conv_w, conv_b, dt_bias,
                                        a_log, d_skip, ssm_norm_w, w_out_ssm)
    q = q.reshape(b, L, ATT_HEADS, ATT_HEAD_DIM)
    k = k.reshape(b, L, ATT_HEADS, ATT_HEAD_DIM)
    v = v.reshape(b, L, ATT_HEADS, ATT_HEAD_DIM)
    if k_past is None:
        o, new_k, new_v = chunk_band_attention_prompt(q, k, v, rel_bias)
    else:
        o, new_k, new_v = chunk_band_attention_step(q, k, v, k_past, v_past, rel_bias)
    y_att = jnp.einsum('bld,de->ble', o * jax.nn.silu(g_att), w_out_att)
    merged = jax.nn.sigmoid(gate_ssm) * y_ssm + jax.nn.sigmoid(gate_att) * y_att
    x = x + jnp.einsum('bld,de->ble', merged, w_o)
    return x, new_h, new_conv, new_k, new_v


def setup_inputs(seed: int = 0) -> dict:
    key = jax.random.key(seed)
    ks = jax.random.split(key, 20)
    f32 = jnp.float32
    att_cache = min(ATT_WINDOW, PAST_LEN)

    def nrm(k, shape, scale):
        return scale * jax.random.normal(k, shape, f32)

    dt = jnp.exp(jax.random.uniform(ks[10], (DEPTH, SSM_HEADS), f32,
                                    math.log(1e-3), math.log(1e-1)))
    return {
        'x_prompt': nrm(ks[0], (BATCH, SEQ, D_MODEL), 1.0),
        'x_sample': nrm(ks[1], (DEC_BATCH, DEC_SEQ, D_MODEL), 1.0),
        'state_ssm': nrm(ks[2], (DEPTH, DEC_BATCH, SSM_HEADS, SSM_HEAD_DIM, D_STATE), 0.1),
        'state_conv': nrm(ks[3], (DEPTH, DEC_BATCH, CONV_W - 1, CONV_DIM), 1.0),
        'cache_k': nrm(ks[4], (DEPTH, DEC_BATCH, att_cache, ATT_HEADS, ATT_HEAD_DIM), 1.0),
        'cache_v': nrm(ks[5], (DEPTH, DEC_BATCH, att_cache, ATT_HEADS, ATT_HEAD_DIM), 1.0),
        'norm_w': 1.0 + nrm(ks[6], (DEPTH, D_MODEL), 0.01),
        'w_in': nrm(ks[7], (DEPTH, D_MODEL, D_IN_PROJ), D_MODEL ** -0.5),
        'conv_w': nrm(ks[8], (DEPTH, CONV_W, CONV_DIM), CONV_W ** -0.5),
        'conv_b': nrm(ks[9], (DEPTH, CONV_DIM), 0.01),
        'dt_bias': dt + jnp.log(-jnp.expm1(-dt)),
        'a_log': jnp.log(jax.random.uniform(ks[11], (DEPTH, SSM_HEADS), f32, 1.0, 16.0)),
        'd_skip': 1.0 + nrm(ks[12], (DEPTH, SSM_HEADS), 0.1),
        'ssm_norm_w': 1.0 + nrm(ks[13], (DEPTH, D_INNER), 0.01),
        'w_out_ssm': nrm(ks[14], (DEPTH, D_INNER, D_MODEL), D_INNER ** -0.5),
        'rel_bias': nrm(ks[15], (DEPTH, ATT_HEADS, 2 * REL_CLIP + 1), 0.1),
        'w_out_att': nrm(ks[16], (DEPTH, D_ATT, D_MODEL), D_ATT ** -0.5),
        'w_o': nrm(ks[17], (DEPTH, D_MODEL, D_MODEL), D_MODEL ** -0.5),
        'final_norm_w': 1.0 + nrm(ks[18], (D_MODEL,), 0.01),
    }


def reference(x_prompt, x_sample, state_ssm, state_conv, cache_k, cache_v,
              norm_w, w_in, conv_w, conv_b, dt_bias, a_log, d_skip, ssm_norm_w,
              w_out_ssm, rel_bias, w_out_att, w_o, final_norm_w):
    h_p, h_s = x_prompt, x_sample
    bp = x_prompt.shape[0]
    h0_p = jnp.zeros((bp, SSM_HEADS, SSM_HEAD_DIM, D_STATE), x_prompt.dtype)
    conv0_p = jnp.zeros((bp, CONV_W - 1, CONV_DIM), x_prompt.dtype)
    ssm_p, conv_p, k_p, v_p = [], [], [], []
    ssm_s, conv_s, k_s, v_s = [], [], [], []
    for l in range(DEPTH):
        lw = (norm_w[l], w_in[l], conv_w[l], conv_b[l], dt_bias[l], a_log[l], d_skip[l],
              ssm_norm_w[l], w_out_ssm[l], rel_bias[l], w_out_att[l], w_o[l])
        h_p, a1, a2, a3, a4 = hybrid_layer(h_p, h0_p, conv0_p, None, None, *lw)
        ssm_p.append(a1); conv_p.append(a2); k_p.append(a3); v_p.append(a4)
        h_s, b1, b2, b3, b4 = hybrid_layer(h_s, state_ssm[l], state_conv[l],
                                           cache_k[l], cache_v[l], *lw)
        ssm_s.append(b1); conv_s.append(b2); k_s.append(b3); v_s.append(b4)
    y_prompt = rmsnorm(h_p, final_norm_w)
    y_sample = rmsnorm(h_s, final_norm_w)
    new_ssm_p = jnp.stack(ssm_p)
    new_conv_p = jnp.stack(conv_p)
    new_k_p = jnp.stack(k_p)
    new_v_p = jnp.stack(v_p)
    new_ssm_s = jnp.stack(ssm_s)
    new_conv_s = jnp.stack(conv_s)
    new_k_s = jnp.stack(k_s)
    new_v_s = jnp.stack(v_s)
    return (y_prompt, y_sample, new_ssm_p, new_conv_p, new_k_p, new_v_p,
            new_ssm_s, new_conv_s, new_k_s, new_v_s)
```

```cpp
#include <hip/hip_runtime.h>
#include <hip/hip_bf16.h>
#include <cstdio>
#include <cstdint>
#include <cmath>

#ifndef MK_N_LAUNCHES
#define MK_N_LAUNCHES 9
#endif

constexpr int DM = 1024;
constexpr int PB = 8, PL = 4096;
constexpr int SB_ = 32, SL = 64;
constexpr int M_P = PB * PL;
constexpr int M_S = SB_ * SL;
constexpr int M = M_P + M_S;
constexpr int NPM = M / 256;
constexpr int DI = 2048, CD = 3072, NHS = 32, DST = 128, NGRP = 4;
constexpr int DA = 1024, AHN = 16, AW = 512;
constexpr int NIN = 11296;
constexpr int N_A = 25 * 256;
constexpr int N_C0 = 20 * 256;
constexpr int NWIN = N_A + N_C0;
constexpr float EPS = 1e-5f;
constexpr float LOG2E = 1.4426950408889634f;
constexpr float QSCALE = 0.125f * LOG2E;

constexpr size_t O_Y = 0;
constexpr size_t O_SSM_P = (size_t)M * DM;
constexpr size_t O_CONV_P = O_SSM_P + (size_t)PB * NHS * 64 * DST;
constexpr size_t O_K_P = O_CONV_P + (size_t)PB * 3 * CD;
constexpr size_t O_V_P = O_K_P + (size_t)PB * AW * DA;
constexpr size_t O_SSM_S = O_V_P + (size_t)PB * AW * DA;
constexpr size_t O_CONV_S = O_SSM_S + (size_t)SB_ * NHS * 64 * DST;
constexpr size_t O_K_S = O_CONV_S + (size_t)SB_ * 3 * CD;
constexpr size_t O_V_S = O_K_S + (size_t)SB_ * AW * DA;
constexpr size_t O_END = O_V_S + (size_t)SB_ * AW * DA;

constexpr size_t MiB = 1u << 20;
constexpr size_t WS_CTL = 0, CTL_ZERO_BYTES = 1 * MiB;
constexpr size_t WS_W1T = 1 * MiB;
constexpr size_t WS_W2T = 5 * MiB;
constexpr size_t WS_W3T = 7 * MiB;
constexpr size_t WS_DT = 9 * MiB;
constexpr size_t WS_HB = 14 * MiB;
constexpr size_t WS_PSQ = 17 * MiB;
constexpr size_t WS_XBC = 22 * MiB;
constexpr size_t WS_Q = 226 * MiB;
constexpr size_t WS_K = 294 * MiB;
constexpr size_t WS_V = 362 * MiB;
constexpr size_t WS_G = 294 * MiB;
constexpr size_t WS_WIN = 430 * MiB;
constexpr size_t WS_MRG = 430 * MiB;
constexpr size_t WS_END = 498 * MiB;
static_assert(WS_XBC + (size_t)M * CD * 2 <= WS_Q && WS_Q + (size_t)M * DM * 2 <= WS_K && WS_V + (size_t)M * DM * 2 <= WS_WIN, "ws map");
static_assert(WS_WIN + (size_t)NWIN * DM * 2 <= WS_END && WS_MRG + (size_t)M * DM * 2 <= WS_END && WS_END <= 512 * MiB, "ws map");
static_assert(WS_DT + (size_t)M * 32 * 4 <= WS_HB && WS_HB + (size_t)NPM * 3 * CD * 2 <= WS_PSQ && WS_PSQ + (size_t)M * 32 * 4 <= WS_XBC, "ws map");


namespace pg8 {
#define PG8_LAS __attribute__((address_space(3)))
typedef unsigned short bf16_t;
typedef short bf16x8 __attribute__((ext_vector_type(8)));
typedef float f32x4 __attribute__((ext_vector_type(4)));
typedef unsigned u32x4 __attribute__((ext_vector_type(4)));
constexpr int BM = 256, BK = 64, HALF = 128, HTB = HALF * BK * 2  , STAGE_BYTES = 8 * HTB, NXCD = 8, WGM = 8;

__host__ __device__ __forceinline__ int lds_byte(int r, int c) { const int st = (r >> 4) * 2 + (c >> 5), rr = r & 15, cc = c & 31, ob = rr * 64 + cc * 2; return st * 1024 + (ob ^ (((ob >> 9) & 1) << 5)); }
__host__ __device__ __forceinline__ void stage_rc(int b, int& R, int& C) { const int st = b / 1024, sb = b % 1024, swz = sb ^ (((sb >> 9) & 1) << 5); R = (st >> 1) * 16 + swz / 64; C = (st & 1) * 32 + (swz % 64) / 2; }
__host__ __device__ __forceinline__ int perm32(int rho) { const int n = rho >> 4, i = rho & 15; return 8 * (i >> 2) + 4 * n + (i & 3); }

struct Unit { int pm, pn; };
struct Gemm { const bf16_t* A; const bf16_t* Bt; int M, N, K, lda; };

struct StaticOrder {
    int nM, nN, nwg, G, c;
    __host__ __device__ void init(int M, int N, int G_, int c_) { nM = M / BM; nN = N / BM; nwg = nM * nN; G = G_; c = c_; }
    __host__ __device__ bool next(int i, Unit& u) const {
        const long L = (long)i * G + c; if (L >= nwg) return false;
        int wgid = (int)L; { const int q = nwg / NXCD, r = nwg % NXCD, xcd = wgid % NXCD, off = wgid / NXCD; wgid = (xcd < r ? xcd * (q + 1) : r * (q + 1) + (xcd - r) * q) + off; }
        const int nig = WGM * nN, gid = wgid / nig, fm = gid * WGM, gsz = (nM - fm) < WGM ? (nM - fm) : WGM;
        u.pm = fm + ((wgid % nig) % gsz); u.pn = (wgid % nig) / gsz; return true;
    }
    __device__ __forceinline__ void a_ready(const Unit&) const {}
    __device__ __forceinline__ void done(const Unit&) const {}
};


template <class Epi, class Sched, bool ALIGN_EPI = false, bool SP2 = false>
__device__ __forceinline__ void gemm_phase(PG8_LAS unsigned char* lds, const Gemm g, const Sched& S, const Epi& E) {
    const int tid = threadIdx.x, wid = __builtin_amdgcn_readfirstlane(tid >> 6), lane = tid & 63, wr = wid >> 2, wc = wid & 3, fr = lane & 15, fq = lane >> 4;
    const int K = g.K, nt = K / BK;
    unsigned voffA[2], voffB[2];
#pragma unroll
    for (int i = 0; i < 2; ++i) { int R, C; stage_rc(tid * 16 + i * 8192, R, C); const int Rb = Epi::PERM ? ((R & ~31) + perm32(R & 31)) : R;
        voffA[i] = (unsigned)(R * g.lda + C) * 2u; voffB[i] = (unsigned)(Rb * K + C) * 2u; }
    const size_t kstep = (size_t)(BK * 2);
    const size_t hstepB = (size_t)HALF * K * 2, hstepA = (size_t)HALF * g.lda * 2;
    const size_t tstepB = 2 * hstepB, tstepA = 2 * hstepA;
    const unsigned ldsw = (unsigned)wid * 1024u;
    const int aoff = lds_byte(wr * 64 + fr, fq * 8), boff = lds_byte(wc * 32 + fr, fq * 8);
#define PG8_SA(b, h) (((b) * 2 + (h)) * HTB)
#define PG8_SB(b, h) ((4 + (b) * 2 + (h)) * HTB)
#define PG8_STAGE(bufoff, gbase, voff) do { _Pragma("unroll") for (int _i = 0; _i < 2; ++_i) \
        __builtin_amdgcn_global_load_lds((const unsigned*)((const char*)(gbase) + (voff)[_i]), (PG8_LAS unsigned*)(lds + (bufoff) + ldsw + _i * 8192), 16, 0, 0); } while (0)
#define PG8_LDA(dst, b, h) do { _Pragma("unroll") for (int m = 0; m < 4; ++m) _Pragma("unroll") for (int k = 0; k < 2; ++k) dst[m][k] = *(const PG8_LAS bf16x8*)(lds + PG8_SA(b, h) + aoff + m * 2048 + k * 1024); } while (0)
#define PG8_LDB(dst, b, h) do { _Pragma("unroll") for (int n = 0; n < 2; ++n) _Pragma("unroll") for (int k = 0; k < 2; ++k) dst[n][k] = *(const PG8_LAS bf16x8*)(lds + PG8_SB(b, h) + boff + n * 2048 + k * 1024); } while (0)
#define PG8_MMA(ai, bj, At, Bt) do { __builtin_amdgcn_s_setprio(1); _Pragma("unroll") for (int m = 0; m < 4; ++m) _Pragma("unroll") for (int n = 0; n < 2; ++n) _Pragma("unroll") for (int k = 0; k < 2; ++k) \
        acc[ai][bj][m][n] = __builtin_amdgcn_mfma_f32_16x16x32_bf16(Bt[n][k], At[m][k], acc[ai][bj][m][n], 0, 0, 0); __builtin_amdgcn_s_setprio(0); } while (0)
#define PG8_WAIT_V(n) asm volatile("s_waitcnt vmcnt(" #n ")" ::: "memory")
#define PG8_WAIT_L(n) asm volatile("s_waitcnt lgkmcnt(" #n ")" ::: "memory")
#define PG8_BAR __builtin_amdgcn_s_barrier()
#define PG8_SCHED __builtin_amdgcn_sched_barrier(0)
    Unit cur, nxt; int ui = 0;
    if (!S.next(0, cur)) return;
    f32x4 acc[2][2][4][2];
#pragma unroll
    for (int a = 0; a < 2; ++a)
#pragma unroll
        for (int b = 0; b < 2; ++b)
#pragma unroll
            for (int m = 0; m < 4; ++m)
#pragma unroll
                for (int n = 0; n < 2; ++n) acc[a][b][m][n] = (f32x4){0.f, 0.f, 0.f, 0.f};
    bf16x8 At[4][2], B0[2][2], B1[2][2];
    const char* cA = (const char*)g.A + (size_t)cur.pm * tstepA; const char* cB = (const char*)g.Bt + (size_t)cur.pn * tstepB;
    S.a_ready(cur);
    if constexpr (SP2) {
        PG8_STAGE(PG8_SB(0, 0), cB, voffB); PG8_STAGE(PG8_SB(0, 1), cB + hstepB, voffB); PG8_STAGE(PG8_SA(0, 0), cA, voffA); PG8_STAGE(PG8_SA(0, 1), cA + hstepA, voffA);
        if (wr == 1) PG8_BAR;
        PG8_WAIT_V(2); PG8_BAR;
        PG8_STAGE(PG8_SB(1, 0), cB + kstep, voffB); PG8_STAGE(PG8_SA(1, 0), cA + kstep, voffA); PG8_STAGE(PG8_SB(1, 1), cB + hstepB + kstep, voffB);
        PG8_WAIT_V(6); PG8_BAR;
    } else {
        PG8_STAGE(PG8_SB(0, 0), cB, voffB); PG8_STAGE(PG8_SA(0, 0), cA, voffA); PG8_STAGE(PG8_SB(0, 1), cB + hstepB, voffB); PG8_STAGE(PG8_SA(0, 1), cA + hstepA, voffA);
        if (wr == 1) PG8_BAR;
        PG8_WAIT_V(4); PG8_BAR;
        PG8_STAGE(PG8_SB(1, 0), cB + kstep, voffB); PG8_STAGE(PG8_SA(1, 0), cA + kstep, voffA); PG8_STAGE(PG8_SB(1, 1), cB + hstepB + kstep, voffB);
        PG8_WAIT_V(6); PG8_BAR;
    }
    for (;;) {
        const bool has_next = S.next(ui + 1, nxt);
        const char* nA = has_next ? (const char*)g.A + (size_t)nxt.pm * tstepA : cA; const char* nB = has_next ? (const char*)g.Bt + (size_t)nxt.pn * tstepB : cB;
        for (int t = 0; t < nt; t += 2) {
            const bool last = (t == nt - 2);
            const char* a1 = cA + (size_t)(t + 1) * kstep;
            const char* a2 = last ? nA : cA + (size_t)(t + 2) * kstep; const char* b2 = last ? nB : cB + (size_t)(t + 2) * kstep;
            const char* a3 = a2 + kstep; const char* b3 = b2 + kstep;
            if (last && has_next) S.a_ready(nxt);
            if constexpr (SP2) {
            PG8_LDB(B0, 0, 0); PG8_LDB(B1, 0, 1); PG8_SCHED; PG8_LDA(At, 0, 0); PG8_STAGE(PG8_SA(1, 1), a1 + hstepA, voffA);
            PG8_WAIT_V(8); PG8_WAIT_L(0); PG8_BAR; PG8_MMA(0, 0, At, B0); PG8_MMA(0, 1, At, B1); PG8_BAR; PG8_SCHED;
            PG8_LDA(At, 0, 1); PG8_STAGE(PG8_SB(0, 0), b2, voffB); PG8_STAGE(PG8_SB(0, 1), b2 + hstepB, voffB); PG8_STAGE(PG8_SA(0, 0), a2, voffA);
            PG8_WAIT_V(8); PG8_WAIT_L(0); PG8_BAR; PG8_MMA(1, 0, At, B0); PG8_MMA(1, 1, At, B1); PG8_BAR; PG8_SCHED;
            PG8_LDB(B0, 1, 0); PG8_LDB(B1, 1, 1); PG8_SCHED; PG8_LDA(At, 1, 0); PG8_STAGE(PG8_SA(0, 1), a2 + hstepA, voffA);
            PG8_WAIT_V(8); PG8_WAIT_L(0); PG8_BAR; PG8_MMA(0, 0, At, B0); PG8_MMA(0, 1, At, B1); PG8_BAR; PG8_SCHED;
            PG8_LDA(At, 1, 1); PG8_STAGE(PG8_SB(1, 0), b3, voffB); PG8_STAGE(PG8_SB(1, 1), b3 + hstepB, voffB); PG8_STAGE(PG8_SA(1, 0), a3, voffA);
            PG8_WAIT_V(8); PG8_WAIT_L(0); PG8_BAR; PG8_MMA(1, 0, At, B0); PG8_MMA(1, 1, At, B1); PG8_BAR; PG8_SCHED;
            } else {
            PG8_LDB(B0, 0, 0); PG8_SCHED; PG8_LDA(At, 0, 0); PG8_STAGE(PG8_SA(1, 1), a1 + hstepA, voffA);
            PG8_WAIT_L(8); PG8_BAR; PG8_WAIT_L(0); PG8_MMA(0, 0, At, B0); PG8_BAR; PG8_SCHED;
            PG8_LDB(B1, 0, 1); PG8_STAGE(PG8_SB(0, 0), b2, voffB);
            PG8_BAR; PG8_WAIT_L(0); PG8_MMA(0, 1, At, B1); PG8_BAR;
            PG8_LDA(At, 0, 1); PG8_STAGE(PG8_SA(0, 0), a2, voffA);
            PG8_BAR; PG8_WAIT_L(0); PG8_MMA(1, 0, At, B0); PG8_BAR; PG8_SCHED;
            PG8_STAGE(PG8_SB(0, 1), b2 + hstepB, voffB);
            PG8_WAIT_V(6); PG8_BAR; PG8_MMA(1, 1, At, B1); PG8_BAR;
            PG8_LDB(B0, 1, 0); PG8_SCHED; PG8_LDA(At, 1, 0); PG8_STAGE(PG8_SA(0, 1), a2 + hstepA, voffA);
            PG8_WAIT_L(8); PG8_BAR; PG8_WAIT_L(0); PG8_MMA(0, 0, At, B0); PG8_BAR; PG8_SCHED;
            PG8_LDB(B1, 1, 1); PG8_STAGE(PG8_SB(1, 0), b3, voffB);
            PG8_BAR; PG8_WAIT_L(0); PG8_MMA(0, 1, At, B1); PG8_BAR;
            PG8_LDA(At, 1, 1); PG8_STAGE(PG8_SA(1, 0), a3, voffA);
            PG8_BAR; PG8_WAIT_L(0); PG8_MMA(1, 0, At, B0); PG8_BAR; PG8_SCHED;
            PG8_STAGE(PG8_SB(1, 1), b3 + hstepB, voffB);
            PG8_WAIT_V(6); PG8_BAR; PG8_MMA(1, 1, At, B1); PG8_BAR;
            }
        }
        if constexpr (ALIGN_EPI) { if (wr == 0) PG8_BAR; }
        if constexpr (!Epi::AFTER_DRAIN) { E(acc, cur, wr, wc, fr, fq); S.done(cur); }
        if (!has_next) break;
#pragma unroll
        for (int a = 0; a < 2; ++a)
#pragma unroll
            for (int b = 0; b < 2; ++b)
#pragma unroll
                for (int m = 0; m < 4; ++m)
#pragma unroll
                    for (int n = 0; n < 2; ++n) acc[a][b][m][n] = (f32x4){0.f, 0.f, 0.f, 0.f};
        cur = nxt; cA = nA; cB = nB; ++ui;
        if constexpr (ALIGN_EPI) { if (wr == 1) PG8_BAR; }
    }
    PG8_WAIT_V(0);
    if constexpr (!ALIGN_EPI) { if (wr == 0) PG8_BAR; }
    PG8_BAR;
    if constexpr (Epi::AFTER_DRAIN) { E.fused(acc, cur, wr, wc, fr, fq, lds, wid, lane); S.done(cur); }
#undef PG8_SA
#undef PG8_SB
#undef PG8_STAGE
#undef PG8_LDA
#undef PG8_LDB
#undef PG8_MMA
#undef PG8_WAIT_V
#undef PG8_WAIT_L
#undef PG8_BAR
#undef PG8_SCHED
}
}


namespace epi {
using pg8::f32x4; using pg8::u32x4; using pg8::Unit; using pg8::bf16_t;
typedef float f32x2_t __attribute__((ext_vector_type(2))); typedef __bf16 bf16x2_t __attribute__((ext_vector_type(2)));
__device__ __forceinline__ unsigned cvtpk(float lo, float hi) { f32x2_t v = {lo, hi}; bf16x2_t b = __builtin_convertvector(v, bf16x2_t); return __builtin_bit_cast(unsigned, b); }
__device__ __forceinline__ float bflo(unsigned w) { return __uint_as_float(w << 16); }
__device__ __forceinline__ float bfhi(unsigned w) { return __uint_as_float(w & 0xffff0000u); }
__device__ __forceinline__ float sigm(float x) { return __builtin_amdgcn_rcpf(1.f + __builtin_amdgcn_exp2f(-x * LOG2E)); }
__device__ __forceinline__ float silu(float x) { return x * sigm(x); }
__device__ __forceinline__ u32x4 pack8(f32x4 a, f32x4 b) { u32x4 w; w.x = cvtpk(a[0], a[1]); w.y = cvtpk(a[2], a[3]); w.z = cvtpk(b[0], b[1]); w.w = cvtpk(b[2], b[3]); return w; }
__device__ __forceinline__ void unpack8(u32x4 w, f32x4& a, f32x4& b) { a = (f32x4){bflo(w.x), bfhi(w.x), bflo(w.y), bfhi(w.y)}; b = (f32x4){bflo(w.z), bfhi(w.z), bflo(w.w), bfhi(w.w)}; }

__device__ __forceinline__ float softplus(float x) { const float t = __expf(-fabsf(x)); const float l = t < 0.01f ? t * (1.f - t * (0.5f - t * 0.33333333f)) : __logf(1.f + t); return fmaxf(x, 0.f) + l; }
struct EpiA {
    static constexpr bool PERM = true, AFTER_DRAIN = false;
    bf16_t *XBC, *HB, *Q, *K, *V; float* DT; const float* dt_bias; float* out;
    __device__ __forceinline__ void operator()(const f32x4 (&acc)[2][2][4][2], const Unit& u, int wr, int wc, int fr, int fq) const {
        const int pn = u.pn, pm = u.pm, rit0 = wr * 64 + fr, cl = wc * 32 + 8 * fq;
        if (pn < 24) {
            bf16_t* B; int ld, ct; float sc = 1.f; float* fo = nullptr; int frow0 = 0; bool halo = false;
            if (pn < 12) { B = XBC; ld = CD; ct = pn * 256; halo = true; }
            else if (pn < 16) { B = Q; ld = DM; ct = (pn - 12) * 256; sc = QSCALE; }
            else { const bool isv = pn >= 20; B = isv ? V : K; ld = DM; ct = (isv ? pn - 20 : pn - 16) * 256;
                if (pm < 128) { const int bt = pm & 15; if (bt >= 14) { fo = out + (isv ? O_V_P : O_K_P) + (size_t)(pm >> 4) * AW * DA + ct; frow0 = (bt - 14) * 256; } }
                else { fo = out + (isv ? O_V_S : O_K_S) + ct; frow0 = -1; } }
#pragma unroll
            for (int ai = 0; ai < 2; ++ai)
#pragma unroll
                for (int m = 0; m < 4; ++m) { const int rit = rit0 + ai * 128 + m * 16; bf16_t* rowp = B + (size_t)(pm * 256 + rit) * ld + ct + cl;
#pragma unroll
                    for (int bj = 0; bj < 2; ++bj) { const u32x4 w = pack8(acc[ai][bj][m][0] * sc, acc[ai][bj][m][1] * sc); *(u32x4*)(rowp + bj * 128) = w;
                        if (halo && ai == 1 && m == 3 && rit >= 253) *(u32x4*)(HB + ((size_t)pm * 3 + (rit - 253)) * CD + ct + cl + bj * 128) = w; }
                    if (fo) { int fr_; if (frow0 >= 0) fr_ = frow0 + rit; else { const int mm = (pm - 128) * 256 + rit; fr_ = (mm >> 6) * AW + (AW - SL) + (mm & 63); }
                        float* fp = fo + (size_t)fr_ * DA + cl;
#pragma unroll
                        for (int bj = 0; bj < 2; ++bj) { *(f32x4*)(fp + bj * 128) = acc[ai][bj][m][0]; *(f32x4*)(fp + bj * 128 + 4) = acc[ai][bj][m][1]; } }
                    asm volatile("" ::: "memory"); }
        } else if (wc == 0) {
#pragma unroll
            for (int ai = 0; ai < 2; ++ai)
#pragma unroll
                for (int m = 0; m < 4; ++m) { const int rit = rit0 + ai * 128 + m * 16;
#pragma unroll
                    for (int n = 0; n < 2; ++n) { const int c = 8 * fq + 4 * n; const f32x4 bv = *(const f32x4*)(dt_bias + c); f32x4 o;
#pragma unroll
                        for (int i = 0; i < 4; ++i) o[i] = softplus(acc[ai][0][m][n][i] + bv[i]);
                        *(f32x4*)(DT + (size_t)(pm * 256 + rit) * 32 + c) = o; }
                    asm volatile("" ::: "memory"); }
        }
    }
};

struct EpiC0 {
    static constexpr bool PERM = true, AFTER_DRAIN = false;
    bf16_t *XBC, *Q, *G; float* PSQ;
    __device__ __forceinline__ void operator()(const f32x4 (&acc)[2][2][4][2], const Unit& u, int wr, int wc, int fr, int fq) const {
        const int pn = u.pn, pm = u.pm, rit0 = wr * 64 + fr, cl = wc * 32 + 8 * fq;
        if (pn < 12) {
            const bool isz = pn < 8; bf16_t* B = isz ? XBC : Q; const int ld = isz ? CD : DM, ct = (isz ? pn : pn - 8) * 256 + cl;
#pragma unroll
            for (int ai = 0; ai < 2; ++ai)
#pragma unroll
                for (int m = 0; m < 4; ++m) { const int row = pm * 256 + rit0 + ai * 128 + m * 16; bf16_t* rowp = B + (size_t)row * ld + ct; float ss = 0.f;
#pragma unroll
                    for (int bj = 0; bj < 2; ++bj) { const u32x4 yv = *(const u32x4*)(rowp + bj * 128); f32x4 y0, y1; unpack8(yv, y0, y1);
                        f32x4 a0 = acc[ai][bj][m][0], a1 = acc[ai][bj][m][1]; asm volatile("" : "+v"(a0), "+v"(a1));
#pragma unroll
                        for (int i = 0; i < 4; ++i) { y0[i] *= silu(a0[i]); y1[i] *= silu(a1[i]); ss += y0[i] * y0[i] + y1[i] * y1[i]; }
                        *(u32x4*)(rowp + bj * 128) = pack8(y0, y1); }
                    if (isz) { ss += __shfl_xor(ss, 16); ss += __shfl_xor(ss, 32); if (fq == 0) PSQ[((size_t)row * 8 + pn) * 4 + wc] = ss; }
                    asm volatile("" ::: "memory"); }
        } else {
            const int ct = (pn - 12) * 256 + cl;
#pragma unroll
            for (int ai = 0; ai < 2; ++ai)
#pragma unroll
                for (int m = 0; m < 4; ++m) { const int row = pm * 256 + rit0 + ai * 128 + m * 16; bf16_t* rowp = G + (size_t)row * 2048 + ct;
#pragma unroll
                    for (int bj = 0; bj < 2; ++bj) { f32x4 a0 = acc[ai][bj][m][0], a1 = acc[ai][bj][m][1]; asm volatile("" : "+v"(a0), "+v"(a1));
#pragma unroll
                        for (int i = 0; i < 4; ++i) { a0[i] = sigm(a0[i]); a1[i] = sigm(a1[i]); }
                        *(u32x4*)(rowp + bj * 128) = pack8(a0, a1); }
                    asm volatile("" ::: "memory"); }
        }
    }
};

template <bool SECOND> struct EpiMerge {
    static constexpr bool PERM = true, AFTER_DRAIN = false;
    const bf16_t* G; bf16_t* MRG;
    __device__ __forceinline__ void operator()(const f32x4 (&acc)[2][2][4][2], const Unit& u, int wr, int wc, int fr, int fq) const {
        const int pn = u.pn, pm = u.pm, rit0 = wr * 64 + fr, ct = pn * 256 + wc * 32 + 8 * fq;
#pragma unroll
        for (int ai = 0; ai < 2; ++ai)
#pragma unroll
            for (int m = 0; m < 4; ++m) { const int row = pm * 256 + rit0 + ai * 128 + m * 16; const bf16_t* gp = G + (size_t)row * 2048 + (SECOND ? 1024 : 0) + ct; bf16_t* mp = MRG + (size_t)row * DM + ct;
#pragma unroll
                for (int bj = 0; bj < 2; ++bj) { f32x4 g0, g1; unpack8(*(const u32x4*)(gp + bj * 128), g0, g1); f32x4 r0 = g0 * acc[ai][bj][m][0], r1 = g1 * acc[ai][bj][m][1];
                    if (SECOND) { f32x4 t0, t1; unpack8(*(const u32x4*)(mp + bj * 128), t0, t1); r0 += t0; r1 += t1; }
                    *(u32x4*)(mp + bj * 128) = pack8(r0, r1); }
                asm volatile("" ::: "memory"); }
    }
};

struct EpiOut {
    static constexpr bool PERM = false, AFTER_DRAIN = false;
    const float *xp, *xs; float* out;
    __device__ __forceinline__ void operator()(const f32x4 (&acc)[2][2][4][2], const Unit& u, int wr, int wc, int fr, int fq) const {
        const int pn = u.pn, pm = u.pm, rit0 = wr * 64 + fr, ct = pn * 256 + wc * 32 + 4 * fq;
        const float* xb = pm < 128 ? xp + (size_t)pm * 256 * DM : xs + (size_t)(pm - 128) * 256 * DM;
#pragma unroll
        for (int ai = 0; ai < 2; ++ai)
#pragma unroll
            for (int m = 0; m < 4; ++m) { const int rit = rit0 + ai * 128 + m * 16; const float* xr = xb + (size_t)rit * DM + ct; float* orow = out + (size_t)(pm * 256 + rit) * DM + ct;
#pragma unroll
                for (int bj = 0; bj < 2; ++bj)
#pragma unroll
                    for (int n = 0; n < 2; ++n) *(f32x4*)(orow + bj * 128 + n * 16) = *(const f32x4*)(xr + bj * 128 + n * 16) + acc[ai][bj][m][n];
                asm volatile("" ::: "memory"); }
    }
};
}


#define LAS __attribute__((address_space(3)))
#define GAS __attribute__((address_space(1)))
typedef short bf16x8 __attribute__((ext_vector_type(8)));
typedef short s16x4 __attribute__((ext_vector_type(4)));
typedef float f32x4 __attribute__((ext_vector_type(4)));
typedef float f32x16 __attribute__((ext_vector_type(16)));
typedef unsigned u32x4 __attribute__((ext_vector_type(4)));
typedef unsigned u32x2 __attribute__((ext_vector_type(2)));
typedef unsigned short bf16;
typedef short v4i16_t __attribute__((ext_vector_type(4)));
__device__ __forceinline__ int crow(int r, int hi) { return (r & 3) + 8 * (r >> 2) + 4 * hi; }
__device__ __forceinline__ void glds16(const void* gsrc, unsigned lds_dst) { unsigned keep;
    asm volatile("s_mov_b32 %0, m0\n\ts_mov_b32 m0, %2\n\ts_nop 0\n\tglobal_load_lds_dwordx4 %1, off\n\ts_mov_b32 m0, %0" : "=&s"(keep) : "v"(gsrc), "s"(lds_dst) : "memory"); }
__device__ __forceinline__ s16x4 vtr(const LAS char* p) { return __builtin_bit_cast(s16x4, __builtin_amdgcn_ds_read_tr16_b64_v4i16((LAS v4i16_t*)p)); }
__device__ __forceinline__ bf16x8 cat8(s16x4 lo, s16x4 hi) { return (bf16x8){lo[0], lo[1], lo[2], lo[3], hi[0], hi[1], hi[2], hi[3]}; }
__device__ __forceinline__ bf16x8 pack_acc8(const f32x16& x, int b) {
    u32x4 w; w.x = epi::cvtpk(x[b], x[b + 1]); w.y = epi::cvtpk(x[b + 2], x[b + 3]); w.z = epi::cvtpk(x[b + 4], x[b + 5]); w.w = epi::cvtpk(x[b + 6], x[b + 7]); return __builtin_bit_cast(bf16x8, w); }
#define MFMA32(a, b, c) __builtin_amdgcn_mfma_f32_32x32x16_bf16((a), (b), (c), 0, 0, 0)

namespace ssd {
constexpr int BUF = 65536, OFF_B = 0, OFF_C = 16384, OFF_X = 32768, OFF_TAB = 131072, LDS_NEED = OFF_TAB + 2 * 4096;
__device__ __forceinline__ int fsw(int row) { return ((row & 3) << 2) | ((row >> 2) & 3); }
__device__ __forceinline__ int bc_off(int row, int ch) { return 256 * row + 16 * (ch ^ fsw(row)); }

struct Task { int tok0; int nchunk; int b; int hgrp; const float* h0; float* hout; };

__device__ __forceinline__ void run(LAS unsigned char* lds, const Task& T, bf16* XBC, const float* DT, const float* a_log, const float* d_skip) {
    const int tid = threadIdx.x, lane = tid & 63, wid = __builtin_amdgcn_readfirstlane(tid >> 6), hh = wid >> 1, ph = wid & 1, r = lane & 31, h = lane >> 5;
    const int head = T.hgrp * 4 + hh, grp = T.hgrp >> 1;
    const unsigned lds0 = (unsigned)(uintptr_t)lds;
    const int hg4 = T.hgrp * 4;
#define SSD_DMA(c, buf) do { const unsigned d0_ = lds0 + (buf) * BUF; const bf16* cb_ = XBC + (size_t)(T.tok0 + (c) * 64) * CD; int ln_ = lane; asm volatile("" : "+v"(ln_)); \
        _Pragma("unroll") for (int k_ = 0; k_ < 2; ++k_) { const int j_ = 2 * wid + k_, row_ = 4 * j_ + (ln_ >> 4), ch_ = (ln_ & 15) ^ fsw(row_); const bf16* sb_ = cb_ + row_ * CD + 2048 + grp * 128 + ch_ * 8; \
            glds16(sb_, (unsigned)__builtin_amdgcn_readfirstlane(d0_ + OFF_B + j_ * 1024)); glds16(sb_ + 512, (unsigned)__builtin_amdgcn_readfirstlane(d0_ + OFF_C + j_ * 1024)); } \
        _Pragma("unroll") for (int k_ = 0; k_ < 4; ++k_) { const int j_ = 4 * wid + k_, q_ = j_ >> 3, jj_ = j_ & 7, row_ = 16 * (jj_ & 3) + (ln_ >> 2); \
            glds16(cb_ + row_ * CD + (hg4 + q_) * 64 + (jj_ >> 2) * 32 + (ln_ & 3) * 8, (unsigned)__builtin_amdgcn_readfirstlane(d0_ + OFF_X + j_ * 1024)); } } while (0)
    const float a2 = -__expf(a_log[head]) * LOG2E;
    const unsigned dbits = epi::cvtpk(d_skip[head], d_skip[head]);
    const bool dq = (h == ((r >> 2) & 1)); const int dks = r >> 4, dj = (r & 3) + 4 * ((r >> 3) & 1);
    u32x4 dmask[2];
#pragma unroll
    for (int ks = 0; ks < 2; ++ks) { const unsigned hm = (dj & 1) ? 0xffff0000u : 0x0000ffffu; const bool on = dq && (dks == ks);
        dmask[ks].x = (on && (dj >> 1) == 0) ? hm : 0u; dmask[ks].y = (on && (dj >> 1) == 1) ? hm : 0u; dmask[ks].z = (on && (dj >> 1) == 2) ? hm : 0u; dmask[ks].w = (on && (dj >> 1) == 3) ? hm : 0u; }
    f32x16 hT[4];
    if (T.h0) {
#pragma unroll
        for (int nb = 0; nb < 4; ++nb)
#pragma unroll
            for (int q = 0; q < 4; ++q) { const f32x4 v = *(const f32x4*)(T.h0 + ((size_t)head * 64 + ph * 32 + r) * DST + 32 * nb + 8 * q + 4 * h);
                hT[nb][4 * q] = v[0]; hT[nb][4 * q + 1] = v[1]; hT[nb][4 * q + 2] = v[2]; hT[nb][4 * q + 3] = v[3]; }
    } else {
#pragma unroll
        for (int nb = 0; nb < 4; ++nb) hT[nb] = f32x16{};
    }
#define SSD_TABLES(dtv, buf) do { if (ph == 0) { float acs_ = (dtv) * a2; \
        _Pragma("unroll") for (int o_ = 1; o_ < 64; o_ <<= 1) { const float t_ = __shfl_up(acs_, o_); if (lane >= o_) acs_ += t_; } \
        const float last_ = __shfl(acs_, 63); LAS float* tb_ = (LAS float*)(lds + OFF_TAB + (buf) * 4096 + hh * 1024); \
        tb_[lane] = acs_; tb_[64 + lane] = -acs_ + __builtin_amdgcn_logf(dtv); tb_[128 + lane] = (dtv) * __builtin_amdgcn_exp2f(last_ - acs_); tb_[192 + lane] = __builtin_amdgcn_exp2f(acs_); } } while (0)
    float dtn = DT[(size_t)(T.tok0 + lane) * 32 + head];
    SSD_TABLES(dtn, 0);
    if (T.nchunk > 1) dtn = DT[(size_t)(T.tok0 + 64 + lane) * 32 + head];
    SSD_DMA(0, 0);
    asm volatile("s_waitcnt vmcnt(0) lgkmcnt(0)" ::: "memory"); __builtin_amdgcn_s_barrier(); asm volatile("" ::: "memory");
    const int fr_ = fsw(r);
    const int xrd = ((lane >> 4) & 1) * 32 + (lane & 3) * 8 + (4 * h + ((lane & 15) >> 2)) * 64;
    const int tq = (lane & 15) >> 2, c2 = 2 * ((lane >> 4) & 1) + ((lane & 3) >> 1);
    for (int c = 0; c < T.nchunk; ++c) {
        const int buf = c & 1;
        int zr = 256 * r, zz = fr_, zx = xrd, zq = tq, zl = 8 * (lane & 1);
        asm volatile("" : "+v"(zr), "+v"(zz), "+v"(zx), "+v"(zq), "+v"(zl));
        const LAS unsigned char* Lb = lds + buf * BUF;
        const LAS float* tab = (const LAS float*)(lds + OFF_TAB + buf * 4096 + hh * 1024);
        if (c + 1 < T.nchunk) {
            SSD_TABLES(dtn, buf ^ 1);
            if (c + 2 < T.nchunk) dtn = DT[(size_t)(T.tok0 + (c + 2) * 64 + lane) * 32 + head];
            SSD_DMA(c + 1, buf ^ 1);
        }
#define SSD_SB() __builtin_amdgcn_sched_barrier(0)
        bf16x8 MT00[2], MT01[2], MT11[2];
        {
        f32x16 cb00 = f32x16{}, cb01 = f32x16{}, cb11 = f32x16{};
#pragma unroll
        for (int ks = 0; ks < 8; ++ks) { const int o = zr + 16 * ((2 * ks + h) ^ zz);
            const bf16x8 a0 = *(const LAS bf16x8*)(Lb + OFF_B + o), a1 = *(const LAS bf16x8*)(Lb + OFF_B + o + 8192);
            const bf16x8 b0 = *(const LAS bf16x8*)(Lb + OFF_C + o), b1 = *(const LAS bf16x8*)(Lb + OFF_C + o + 8192);
            cb00 = MFMA32(a0, b0, cb00); cb01 = MFMA32(a0, b1, cb01); cb11 = MFMA32(a1, b1, cb11); }
        const float al0 = tab[r], al1 = tab[32 + r];
#pragma unroll
        for (int q = 0; q < 4; ++q) { const f32x4 e0 = *(const LAS f32x4*)(tab + 64 + 8 * q + 4 * h), e1 = *(const LAS f32x4*)(tab + 64 + 32 + 8 * q + 4 * h);
#pragma unroll
            for (int i = 0; i < 4; ++i) { const int rg = 4 * q + i, sl = 8 * q + 4 * h + i;
                const float m00 = cb00[rg] * __builtin_amdgcn_exp2f(al0 + e0[i]), m01 = cb01[rg] * __builtin_amdgcn_exp2f(al1 + e0[i]), m11 = cb11[rg] * __builtin_amdgcn_exp2f(al1 + e1[i]);
                cb00[rg] = (sl <= r) ? m00 : 0.f; cb01[rg] = m01; cb11[rg] = (sl <= r) ? m11 : 0.f; } }
#pragma unroll
        for (int ks = 0; ks < 2; ++ks) { MT00[ks] = pack_acc8(cb00, 8 * ks); MT01[ks] = pack_acc8(cb01, 8 * ks); MT11[ks] = pack_acc8(cb11, 8 * ks); }
        }
        SSD_SB();
        f32x16 y0 = f32x16{}, y1 = f32x16{};
#pragma unroll
        for (int nb = 0; nb < 4; ++nb)
#pragma unroll
            for (int ks = 0; ks < 2; ++ks) { const bf16x8 hb = pack_acc8(hT[nb], 8 * ks);
                const int o0 = zr + 16 * ((4 * nb + 2 * ks) ^ zz) + 8 * h, o1 = zr + 16 * ((4 * nb + 2 * ks + 1) ^ zz) + 8 * h;
                const s16x4 p0 = *(const LAS s16x4*)(Lb + OFF_C + o0), p1 = *(const LAS s16x4*)(Lb + OFF_C + o1);
                const s16x4 q0 = *(const LAS s16x4*)(Lb + OFF_C + o0 + 8192), q1 = *(const LAS s16x4*)(Lb + OFF_C + o1 + 8192);
                y0 = MFMA32(cat8(p0, p1), hb, y0); y1 = MFMA32(cat8(q0, q1), hb, y1); }
#pragma unroll
        for (int q = 0; q < 4; ++q) { const f32x4 f0 = *(const LAS f32x4*)(tab + 192 + 8 * q + 4 * h), f1v = *(const LAS f32x4*)(tab + 192 + 32 + 8 * q + 4 * h);
#pragma unroll
            for (int i = 0; i < 4; ++i) { y0[4 * q + i] *= f0[i]; y1[4 * q + i] *= f1v[i]; } }
        SSD_SB();
        const LAS char* xw = (const LAS char*)(Lb + OFF_X + hh * 8192 + ph * 4096) + zx;
        bf16x8 XF[2][2];
#pragma unroll
        for (int sb = 0; sb < 2; ++sb)
#pragma unroll
            for (int ks = 0; ks < 2; ++ks) XF[sb][ks] = cat8(vtr(xw + (32 * sb + 16 * ks) * 64), vtr(xw + (32 * sb + 16 * ks) * 64 + 512));
#pragma unroll
        for (int ks = 0; ks < 2; ++ks) { u32x4 dw; dw.x = dbits & dmask[ks].x; dw.y = dbits & dmask[ks].y; dw.z = dbits & dmask[ks].z; dw.w = dbits & dmask[ks].w; const bf16x8 DIk = __builtin_bit_cast(bf16x8, dw);
            y0 = MFMA32(MT00[ks], XF[0][ks], y0); y0 = MFMA32(DIk, XF[0][ks], y0);
            y1 = MFMA32(MT01[ks], XF[0][ks], y1); y1 = MFMA32(MT11[ks], XF[1][ks], y1); y1 = MFMA32(DIk, XF[1][ks], y1); }
        SSD_SB();
        bf16x8 XB[2][2];
#pragma unroll
        for (int sb = 0; sb < 2; ++sb) { const unsigned wb = epi::cvtpk(tab[128 + 32 * sb + r], tab[128 + 32 * sb + r]); f32x16 xe = f32x16{};
#pragma unroll
            for (int ks = 0; ks < 2; ++ks) { u32x4 w; w.x = wb & dmask[ks].x; w.y = wb & dmask[ks].y; w.z = wb & dmask[ks].z; w.w = wb & dmask[ks].w; xe = MFMA32(__builtin_bit_cast(bf16x8, w), XF[sb][ks], xe); }
            XB[sb][0] = pack_acc8(xe, 0); XB[sb][1] = pack_acc8(xe, 8); }
        SSD_SB();
        { LAS bf16* yt = (LAS bf16*)(Lb + OFF_X + hh * 8192 + ph * 4096);
          asm volatile("s_waitcnt lgkmcnt(0)" ::: "memory");
#pragma unroll
          for (int rg = 0; rg < 16; ++rg) { yt[crow(rg, h) * 32 + r] = (bf16)(epi::cvtpk(y0[rg], 0.f) & 0xffffu); yt[(32 + crow(rg, h)) * 32 + r] = (bf16)(epi::cvtpk(y1[rg], 0.f) & 0xffffu); }
          asm volatile("s_waitcnt lgkmcnt(0)" ::: "memory");
          bf16* yg = XBC + (size_t)(T.tok0 + c * 64) * CD + head * 64 + ph * 32;
#pragma unroll
          for (int k = 0; k < 4; ++k) { const int row = 16 * k + (lane >> 2), pc = lane & 3; const u32x4 v = *(const LAS u32x4*)((const LAS char*)yt + row * 64 + pc * 16);
              *(u32x4*)(yg + (size_t)row * CD + pc * 8) = v; } }
        SSD_SB();
        { const float etot = tab[192 + 63];
#pragma unroll
        for (int nb = 0; nb < 4; ++nb) hT[nb] *= etot;
#pragma unroll
        for (int sb = 0; sb < 2; ++sb)
#pragma unroll
            for (int ks = 0; ks < 2; ++ks) { const int S0 = 32 * sb + 16 * ks + 4 * h + zq; const int g1 = (zq << 2) | h, g2 = (zq << 2) | (h + 2);
#pragma unroll
                for (int nb = 0; nb < 4; ++nb) { const int ch = 4 * nb + c2;
                    const s16x4 t0 = vtr((const LAS char*)(Lb + OFF_B + 256 * S0 + 16 * (ch ^ g1) + zl));
                    const s16x4 t1 = vtr((const LAS char*)(Lb + OFF_B + 256 * (S0 + 8) + 16 * (ch ^ g2) + zl));
                    hT[nb] = MFMA32(cat8(t0, t1), XB[sb][ks], hT[nb]); } } }
        asm volatile("s_waitcnt vmcnt(0) lgkmcnt(0)" ::: "memory"); __builtin_amdgcn_s_barrier(); asm volatile("" ::: "memory");
    }
#pragma unroll
    for (int nb = 0; nb < 4; ++nb)
#pragma unroll
        for (int q = 0; q < 4; ++q) *(f32x4*)(T.hout + ((size_t)head * 64 + ph * 32 + r) * DST + 32 * nb + 8 * q + 4 * h) = (f32x4){hT[nb][4 * q], hT[nb][4 * q + 1], hT[nb][4 * q + 2], hT[nb][4 * q + 3]};
#undef SSD_DMA
#undef SSD_SB
#undef SSD_TABLES
}
}

typedef unsigned v4u __attribute__((ext_vector_type(4)));
typedef GAS unsigned gu32;
typedef GAS unsigned long long gu64;
#define RLX_AGENT __ATOMIC_RELAXED, __HIP_MEMORY_SCOPE_AGENT
#define LDS_WAIT() asm volatile("s_waitcnt lgkmcnt(0)" ::: "memory")
#define VM_WAIT() asm volatile("s_waitcnt vmcnt(0)" ::: "memory")
__device__ __forceinline__ unsigned long long rt() { return __builtin_amdgcn_s_memrealtime(); }
__device__ __forceinline__ unsigned f2bf(float f) { unsigned u = __builtin_bit_cast(unsigned, f); return (u + 0x7fffu + ((u >> 16) & 1u)) >> 16; }
__device__ __forceinline__ unsigned pk2(float lo, float hi) { return f2bf(lo) | (f2bf(hi) << 16); }

#define XB_TMO      128
#define XB_XCNT(j)  (256  + 64 * (j))
#define XB_XSUB(j)  (1280 + 64 * (j))
#define XB_XGEN(j)  (2304 + 64 * (j))
#define XB_TOP      3328
#define XB_TOPGEN   3392
#define XCD_BAR_WORDS 3456
#define XB_SPIN_CAP (1u << 18)

__device__ __forceinline__ unsigned xb_ld(unsigned* p)              { return __hip_atomic_load(p, __ATOMIC_RELAXED, __HIP_MEMORY_SCOPE_AGENT); }
__device__ __forceinline__ unsigned xb_add(unsigned* p, unsigned v) { return __hip_atomic_fetch_add(p, v, __ATOMIC_RELAXED, __HIP_MEMORY_SCOPE_AGENT); }
__device__ __forceinline__ unsigned xb_xcc_id() { return (unsigned)__builtin_amdgcn_s_getreg((3 << 11) | 20) & 0xFu; }
#define XB_SPIN(cond, bar) do { unsigned _sp = 0; while (cond) { __builtin_amdgcn_s_sleep(1); \
    if ((++_sp & 255u) == 0u) { if (xb_ld(&(bar)[XB_TMO])) break; if (_sp > XB_SPIN_CAP) { atomicAdd(&(bar)[XB_TMO], 1u); break; } } } } while (0)

struct XcdBarrier {
    unsigned* bar; unsigned x;
    volatile LAS unsigned* st;
};

__device__ __forceinline__ XcdBarrier xcd_barrier_post(unsigned* bar, volatile LAS unsigned* st) {
    XcdBarrier b; b.bar = bar; b.x = xb_xcc_id(); b.st = st;
    if (threadIdx.x == 0) (void)xb_add(&bar[XB_XCNT(b.x)], 1u);
    return b;
}
__device__ __forceinline__ void xcd_barrier_complete(unsigned* bar, unsigned x, unsigned& nloc, unsigned& nx) {
    const unsigned G = gridDim.x * gridDim.y * gridDim.z;
    unsigned sum, cnt, mine, sp = 0u;
    for (;;) {
        sum = 0u; cnt = 0u; mine = 0u;
#pragma unroll
        for (unsigned j = 0; j < 16; ++j) { const unsigned c = xb_ld(&bar[XB_XCNT(j)]); sum += c; cnt += (c > 0u) ? 1u : 0u; mine = (j == x) ? c : mine; }
        if (sum == G) break;
        __builtin_amdgcn_s_sleep(1);
        if ((++sp & 255u) == 0u) { if (xb_ld(&bar[XB_TMO])) break; if (sp > XB_SPIN_CAP) { atomicAdd(&bar[XB_TMO], 1u); break; } }
    }
    nloc = mine > 0u ? mine : 1u; nx = cnt > 0u ? cnt : 1u;
}

__device__ __forceinline__ void xcd_barrier(const XcdBarrier& b) {
    asm volatile("s_waitcnt vmcnt(0)" ::: "memory");
    __syncthreads();
    if (threadIdx.x == 0) {
        unsigned* bar = b.bar;
        __builtin_amdgcn_s_waitcnt(0);
        unsigned nloc = b.st[0], nx = b.st[1];
        if (nloc == 0u) { xcd_barrier_complete(bar, b.x, nloc, nx); b.st[0] = nloc; b.st[1] = nx; }
        const unsigned old = xb_add(&bar[XB_XSUB(b.x)], 1u);
        const unsigned gen = old / nloc;
        if (old + 1u == (gen + 1u) * nloc) {
            __builtin_amdgcn_fence(__ATOMIC_RELEASE, "agent");
            asm volatile("s_waitcnt vmcnt(0)" ::: "memory");
            const unsigned og = xb_add(&bar[XB_TOP], 1u);
            const unsigned tg = og / nx;
            if (og + 1u == (tg + 1u) * nx) xb_add(&bar[XB_TOPGEN], 1u);
            else XB_SPIN(xb_ld(&bar[XB_TOPGEN]) == tg, bar);
            __builtin_amdgcn_fence(__ATOMIC_ACQUIRE, "agent");
            xb_add(&bar[XB_XGEN(b.x)], 1u);
            asm volatile("s_waitcnt vmcnt(0)" ::: "memory");
        } else {
            XB_SPIN(xb_ld(&bar[XB_XGEN(b.x)]) == gen, bar);
            __builtin_amdgcn_fence(__ATOMIC_ACQUIRE, "agent");
            asm volatile("s_waitcnt vmcnt(0)" ::: "memory");
        }
    }
    __syncthreads();
}


namespace att {
constexpr int L_K = 0, L_V = 16384, L_WS = 32768, L_OST = 34816, L_TB = 67584, LDS_NEED = L_TB + 2560;
struct Unit { int sample; int b, h, qb; };

__device__ __forceinline__ float rowmax32(const f32x16& p0, const f32x16& p1) {
    float a = fmaxf(fmaxf(p0[0], p0[1]), p1[0]), b = fmaxf(fmaxf(p0[2], p0[3]), p1[1]); a = fmaxf(fmaxf(a, p1[2]), p1[3]);
#pragma unroll
    for (int r = 4; r < 16; r += 4) { a = fmaxf(fmaxf(a, p0[r]), p0[r + 1]); b = fmaxf(fmaxf(b, p0[r + 2]), p0[r + 3]); a = fmaxf(fmaxf(a, p1[r]), p1[r + 1]); b = fmaxf(fmaxf(b, p1[r + 2]), p1[r + 3]); }
    const float m = fmaxf(a, b);
    auto rr = __builtin_amdgcn_permlane32_swap(__float_as_uint(m), __float_as_uint(m), false, false);
    return fmaxf(__uint_as_float(rr[0]), __uint_as_float(rr[1]));
}

__device__ __forceinline__ void unit(LAS unsigned char* lds, const Unit& U, bf16* Q, const bf16* K, const bf16* V, const float* cache_k, const float* cache_v, const float* rel_bias) {
    const int tid = threadIdx.x, lane = tid & 63, r32 = lane & 31, hi = lane >> 5, wid = __builtin_amdgcn_readfirstlane(tid >> 6), half = wid & 1;
    const int h = U.h;
    LAS float* TB = (LAS float*)(lds + L_TB);
    for (int k = tid; k < 640; k += 512) { int d = k - 63; d = d > 256 ? 256 : d; TB[k] = rel_bias[h * 513 + d + 256] * LOG2E; }
    int cw, t_lo, t_hi; size_t qrow0, krow0;
    if (!U.sample) { cw = 4 * U.qb + (wid >> 1); t_lo = 4 * U.qb - 8 < 0 ? 0 : 4 * U.qb - 8; t_hi = 4 * U.qb + 3; qrow0 = (size_t)U.b * PL + 64 * cw + 32 * half; krow0 = (size_t)U.b * PL; }
    else { cw = wid < 2 ? 8 : -100; t_lo = 0; t_hi = 8; qrow0 = (size_t)M_P + U.b * SL + 32 * half; krow0 = (size_t)M_P + U.b * SL; }
    const bool qact = cw >= 0;
    bf16x8 qr[4];
#pragma unroll
    for (int d0 = 0; d0 < 4; ++d0) qr[d0] = qact ? *(const bf16x8*)(Q + (qrow0 + r32) * DM + h * 64 + d0 * 16 + hi * 8) : bf16x8{};
    float mrun = -1e30f, lrun = 0.f; f32x16 o[2]; o[0] = f32x16{}; o[1] = f32x16{};
    LAS float* wsf = (LAS float*)(lds + L_WS) + wid * 64;
    const int vrow = 16 * (wid & 3) + (lane >> 2), vcol = (wid >> 2) * 32 + (lane & 3) * 8;
    u32x4 kreg, vreg;
#define ATT_LOAD(t) do { if (!U.sample || (t) == 8) { const size_t rb_ = U.sample ? krow0 : krow0 + (size_t)(t) * 64; \
            kreg = *(const u32x4*)(K + (rb_ + lane) * DM + h * 64 + wid * 8); vreg = *(const u32x4*)(V + (rb_ + vrow) * DM + h * 64 + vcol); } \
        else { const float* kp_ = cache_k + (((size_t)U.b * AW + (t) * 64 + lane) * AHN + h) * 64 + wid * 8; const float* vp_ = cache_v + (((size_t)U.b * AW + (t) * 64 + vrow) * AHN + h) * 64 + vcol; \
            kreg = epi::pack8(*(const f32x4*)kp_, *(const f32x4*)(kp_ + 4)); vreg = epi::pack8(*(const f32x4*)vp_, *(const f32x4*)(vp_ + 4)); } } while (0)
#define ATT_STORE(buf) do { *(LAS u32x4*)(lds + L_K + (buf) * 8192 + wid * 1024 + lane * 16) = kreg; *(LAS u32x4*)(lds + L_V + (buf) * 8192 + wid * 1024 + lane * 16) = vreg; } while (0)
    ATT_LOAD(t_lo); ATT_STORE(0);
    __syncthreads();
    const int vb0 = ((lane >> 4) & 1) * 32 + (lane & 3) * 8 + (4 * hi + ((lane & 15) >> 2)) * 64;
    for (int t = t_lo; t <= t_hi; ++t) {
        const int buf = (t - t_lo) & 1;
        if (t < t_hi) ATT_LOAD(t + 1);
        if (t >= cw - 8 && t <= cw) {
            const int tt = t - (cw - 8);
            const int kb = 575 + 32 * half + r32 - 64 * tt - 4 * hi;
            f32x16 p0, p1;
#pragma unroll
            for (int rg = 0; rg < 16; ++rg) { const int o_ = (rg & 3) + 8 * (rg >> 2); p0[rg] = TB[kb - o_]; p1[rg] = TB[kb - 32 - o_]; }
            const LAS char* kbp = (const LAS char*)(lds + L_K + buf * 8192) + hi * 1024 + r32 * 16;
#pragma unroll
            for (int d0 = 0; d0 < 4; ++d0) { const bf16x8 b0 = *(const LAS bf16x8*)(kbp + d0 * 2048), b1 = *(const LAS bf16x8*)(kbp + d0 * 2048 + 512);
                p0 = MFMA32(b0, qr[d0], p0); p1 = MFMA32(b1, qr[d0], p1); }
            const float rm = rowmax32(p0, p1), mnew = fmaxf(mrun, rm), alpha = __builtin_amdgcn_exp2f(mrun - mnew); mrun = mnew;
            float ls = 0.f;
#pragma unroll
            for (int rg = 0; rg < 16; ++rg) { p0[rg] = __builtin_amdgcn_exp2f(p0[rg] - mnew); p1[rg] = __builtin_amdgcn_exp2f(p1[rg] - mnew); ls += p0[rg] + p1[rg]; }
            lrun = lrun * alpha + ls;
            if (hi == 0) wsf[r32] = alpha;
            asm volatile("s_waitcnt lgkmcnt(0)" ::: "memory");
#pragma unroll
            for (int rg = 0; rg < 16; ++rg) { const float f = wsf[crow(rg, hi)]; o[0][rg] *= f; o[1][rg] *= f; }
            const bf16x8 pa0 = pack_acc8(p0, 0), pa1 = pack_acc8(p0, 8), pa2 = pack_acc8(p1, 0), pa3 = pack_acc8(p1, 8);
            const LAS char* vp = (const LAS char*)(lds + L_V + buf * 8192) + vb0;
#pragma unroll
            for (int d0 = 0; d0 < 2; ++d0) {
                o[d0] = MFMA32(pa0, cat8(vtr(vp + d0 * 4096), vtr(vp + d0 * 4096 + 512)), o[d0]);
                o[d0] = MFMA32(pa1, cat8(vtr(vp + d0 * 4096 + 1024), vtr(vp + d0 * 4096 + 1024 + 512)), o[d0]);
                o[d0] = MFMA32(pa2, cat8(vtr(vp + d0 * 4096 + 2048), vtr(vp + d0 * 4096 + 2048 + 512)), o[d0]);
                o[d0] = MFMA32(pa3, cat8(vtr(vp + d0 * 4096 + 3072), vtr(vp + d0 * 4096 + 3072 + 512)), o[d0]); }
        }
        if (t < t_hi) ATT_STORE(buf ^ 1);
        __syncthreads();
    }
    if (qact) {
        { auto rr = __builtin_amdgcn_permlane32_swap(__float_as_uint(lrun), __float_as_uint(lrun), false, false); lrun = __uint_as_float(rr[0]) + __uint_as_float(rr[1]); }
        if (hi == 0) wsf[32 + r32] = lrun;
        asm volatile("s_waitcnt lgkmcnt(0)" ::: "memory");
        LAS bf16* stg = (LAS bf16*)(lds + L_OST) + wid * 2048;
#pragma unroll
        for (int rg = 0; rg < 16; ++rg) { const int orow = crow(rg, hi); const float rl = __builtin_amdgcn_rcpf(wsf[32 + orow]);
#pragma unroll
            for (int d0 = 0; d0 < 2; ++d0) stg[orow * 64 + d0 * 32 + r32] = (bf16)(epi::cvtpk(o[d0][rg] * rl, 0.f) & 0xffffu); }
        asm volatile("s_waitcnt lgkmcnt(0)" ::: "memory");
        bf16* Ow = Q + qrow0 * DM + h * 64;
#pragma unroll
        for (int i = 0; i < 4; ++i) { const int row = i * 8 + (lane >> 3), ch = lane & 7; const u32x4 v = *(const LAS u32x4*)(stg + row * 64 + ch * 8); *(u32x4*)(Ow + (size_t)row * DM + ch * 8) = v; }
    }
    __syncthreads();
#undef ATT_LOAD
#undef ATT_STORE
}
}


constexpr int NWAVES = 8;
constexpr int N_PHASES = 9;
constexpr int N_LAUNCHES = MK_N_LAUNCHES;
constexpr int RING_OFF = 0, RING_BYTES = 131072 + 8192;
constexpr int LDSCTL_OFF = RING_BYTES, MISC_OFF = LDSCTL_OFF + 320;
constexpr int LDS_BYTES = 147456;
static_assert(ssd::LDS_NEED <= RING_BYTES && att::LDS_NEED <= RING_BYTES && MISC_OFF + 128 <= LDS_BYTES, "LDS map");
constexpr int CW_TMO = 0, CW_CODE = 1, CW_BAR = 4096;

struct Args { const float* in[19]; float* out; unsigned char* ws; int ph_lo, ph_hi, li, pad; };

__device__ __forceinline__ float wave_sum(float v) {
#pragma unroll
    for (int o = 1; o < 64; o <<= 1) v += __shfl_xor(v, o);
    return v;
}
__device__ __forceinline__ void p0_transpose_item(const float* W, int ldw, int c0, int K, int ncols, bf16* WT, int r0, const float* kscale, LAS float* scr, int item, int lane) {
    const int nblk = ncols / 32, kb = item / nblk, nb = item % nblk, k0 = 64 * kb, n0 = 32 * nb;
#pragma unroll 8
    for (int i = 0; i < 32; ++i) { const int kk = 2 * i + (lane >> 5); float v = W[(size_t)(k0 + kk) * ldw + c0 + n0 + (lane & 31)]; if (kscale) v *= kscale[k0 + kk]; scr[kk * 33 + (lane & 31)] = v; }
    LDS_WAIT(); asm volatile("" ::: "memory");
    const int c = lane & 7;
#pragma unroll
    for (int j = 0; j < 4; ++j) { const int n = (lane >> 3) + 8 * j; const LAS float* s = scr + (8 * c) * 33 + n;
        v4u o; o.x = pk2(s[0 * 33], s[1 * 33]); o.y = pk2(s[2 * 33], s[3 * 33]); o.z = pk2(s[4 * 33], s[5 * 33]); o.w = pk2(s[6 * 33], s[7 * 33]);
        *(GAS v4u*)(WT + (size_t)(r0 + n0 + n) * K + k0 + 8 * c) = o; }
    LDS_WAIT(); asm volatile("" ::: "memory");
}

__global__ void __launch_bounds__(NWAVES * 64, 2) mk_fwd(Args args) {
    extern __shared__ __attribute__((aligned(16))) unsigned char lds_raw[];
    LAS unsigned char* lds = (LAS unsigned char*)lds_raw;
    volatile LAS unsigned* MISC = (volatile LAS unsigned*)(lds + MISC_OFF);
    const int tid = threadIdx.x, lane = tid & 63, wave = __builtin_amdgcn_readfirstlane(tid >> 6);
    const int G = gridDim.x, bx = blockIdx.x;
    const int vcu = (G % 8 == 0) ? (bx % 8) * (G / 8) + bx / 8 : bx;
    unsigned char* ws = args.ws; float* out = args.out;
    gu32* ctl = (gu32*)(ws + WS_CTL);
    const float* x_p = args.in[0]; const float* x_s = args.in[1]; const float* state_ssm = args.in[2]; const float* state_conv = args.in[3];
    const float* cache_k = args.in[4]; const float* cache_v = args.in[5]; const float* norm_w = args.in[6]; const float* w_in = args.in[7];
    const float* conv_w = args.in[8]; const float* conv_b = args.in[9]; const float* dt_bias = args.in[10]; const float* a_log = args.in[11];
    const float* d_skip = args.in[12]; const float* ssm_norm_w = args.in[13]; const float* w_out_ssm = args.in[14]; const float* rel_bias = args.in[15];
    const float* w_out_att = args.in[16]; const float* w_o = args.in[17]; const float* final_norm_w = args.in[18];
    bf16* W1T = (bf16*)(ws + WS_W1T); bf16* W2T = (bf16*)(ws + WS_W2T); bf16* W3T = (bf16*)(ws + WS_W3T); bf16* WIN = (bf16*)(ws + WS_WIN);
    float* DT = (float*)(ws + WS_DT); bf16* HB = (bf16*)(ws + WS_HB); float* PSQ = (float*)(ws + WS_PSQ);
    bf16* XBC = (bf16*)(ws + WS_XBC); bf16* QB = (bf16*)(ws + WS_Q); bf16* KB = (bf16*)(ws + WS_K); bf16* VB = (bf16*)(ws + WS_V);
    bf16* GB = (bf16*)(ws + WS_G); bf16* MRG = (bf16*)(ws + WS_MRG); bf16* XN = (bf16*)out;

    for (int u = tid; u < (LDS_BYTES - LDSCTL_OFF) / 4; u += NWAVES * 64) ((LAS unsigned*)(lds + LDSCTL_OFF))[u] = 0u;
    __syncthreads();
    XcdBarrier bar; bar.bar = (unsigned*)(ctl + CW_BAR); bar.x = 0; bar.st = nullptr;
    if (N_LAUNCHES == 1) bar = xcd_barrier_post((unsigned*)(ctl + CW_BAR), MISC + 8);
#define GRID_BAR() do { if (N_LAUNCHES == 1) xcd_barrier(bar); } while (0)
    const int lo = args.ph_lo, hi = args.ph_hi;
#ifndef PH_MASK
#define PH_MASK 0x1ff
#endif
#define IN(k) (((PH_MASK >> (k)) & 1) && lo <= (k) && (k) < hi)
#define BOTH(k) (IN(k) && IN((k) + 1))
    const int gw = vcu * NWAVES + wave, NGW = G * NWAVES, gt = vcu * (NWAVES * 64) + tid, NGT = G * NWAVES * 64;

    if (IN(0)) {
        LAS float* scr = (LAS float*)(lds + RING_OFF + wave * 16384);
        constexpr int NSEG = 9;
        constexpr int sc0[NSEG] = {2048, 5152, 6176, 7200, 5120, 0, 8224, 9248, 10272}; constexpr int snc[NSEG] = {3072, 1024, 1024, 1024, 32, 2048, 1024, 1024, 1024}; constexpr int sr0[NSEG] = {0, 3072, 4096, 5120, 6144, 6400, 8448, 9472, 10496};
        constexpr int I_IN = 16 * (NIN / 32), I_1 = 32 * 32, I_2 = 16 * 32, NITEMS = I_IN + I_1 + 2 * I_2;
        for (int it = gw; it < NITEMS; it += NGW) {
            int rI = it;
            if (rI < I_IN) { int c0 = 0, nc = 32, r0 = 0; bool found = false;
#pragma unroll
                for (int q = 0; q < NSEG; ++q) { const int ni = 16 * (snc[q] / 32); if (!found) { if (rI < ni) { c0 = sc0[q]; nc = snc[q]; r0 = sr0[q]; found = true; } else rI -= ni; } }
                p0_transpose_item(w_in, NIN, c0, DM, nc, WIN, r0, nullptr, scr, rI, lane); continue; }
            rI -= I_IN;
            if (rI < I_1) { p0_transpose_item(w_out_ssm, DM, 0, DI, DM, W1T, 0, ssm_norm_w, scr, rI, lane); continue; }
            rI -= I_1;
            if (rI < I_2) { p0_transpose_item(w_out_att, DM, 0, DA, DM, W2T, 0, nullptr, scr, rI, lane); continue; }
            rI -= I_2;
            p0_transpose_item(w_o, DM, 0, DM, DM, W3T, 0, nullptr, scr, rI, lane);
        }
        for (int i = gt; i < (6400 - 6176) * DM / 8; i += NGT) *(GAS v4u*)(WIN + (size_t)6176 * DM + (size_t)i * 8) = (v4u){0u, 0u, 0u, 0u};
        for (int m = gw; m < M; m += NGW) {
            const float* xrow = m < M_P ? x_p + (size_t)m * DM : x_s + (size_t)(m - M_P) * DM;
            const GAS f32x4* xr = (const GAS f32x4*)xrow + lane; f32x4 v[4]; float s2 = 0.f;
#pragma unroll
            for (int j = 0; j < 4; ++j) { v[j] = xr[64 * j]; s2 += (v[j].x * v[j].x + v[j].y * v[j].y) + (v[j].z * v[j].z + v[j].w * v[j].w); }
            const float rstd = 1.f / sqrtf(wave_sum(s2) * (1.f / DM) + EPS);
            GAS unsigned long long* o8 = (GAS unsigned long long*)(XN + (size_t)m * DM) + lane;
#pragma unroll
            for (int j = 0; j < 4; ++j) { const f32x4 w = *((const f32x4*)norm_w + 64 * j + lane);
                o8[64 * j] = (unsigned long long)pk2(v[j].x * rstd * w.x, v[j].y * rstd * w.y) | ((unsigned long long)pk2(v[j].z * rstd * w.z, v[j].w * rstd * w.w) << 32); }
        }
        { constexpr int PER = SB_ * (AW - SL) * (DA / 4);
          for (int i = gt; i < 2 * PER; i += NGT) { const int tsel = i >= PER, j = tsel ? i - PER : i, b = j / ((AW - SL) * (DA / 4)), rem = j % ((AW - SL) * (DA / 4));
              const float* src = (tsel ? cache_v : cache_k) + ((size_t)b * AW + SL) * DA + (size_t)rem * 4; float* dst = out + (tsel ? O_V_S : O_K_S) + (size_t)b * AW * DA + (size_t)rem * 4;
              *(f32x4*)dst = *(const f32x4*)src; } }
        if (BOTH(0)) GRID_BAR();
    }

    if (IN(1)) {
        pg8::Gemm g{XN, WIN, M, N_A, DM, DM}; pg8::StaticOrder S; S.init(M, N_A, G, bx);
        epi::EpiA E{XBC, HB, QB, KB, VB, DT, dt_bias, out};
        pg8::gemm_phase<epi::EpiA, pg8::StaticOrder, true, true>(lds + RING_OFF, g, S, E);
        if (BOTH(1)) GRID_BAR();
    }

    if (IN(2)) {
        const int strip = lane, seg = wave;
        for (int u = vcu; u < NPM * 6; u += G) {
            const int pm = u / 6, cg = u % 6, col = cg * 512 + strip * 8, row0 = pm * 256 + seg * 32;
            float w[4][8], bia[8], hw[3][8];
#pragma unroll
            for (int j = 0; j < 4; ++j) { const f32x4 a = *(const f32x4*)(conv_w + j * CD + col), b = *(const f32x4*)(conv_w + j * CD + col + 4);
#pragma unroll
                for (int i = 0; i < 4; ++i) { w[j][i] = a[i]; w[j][4 + i] = b[i]; } }
            { const f32x4 a = *(const f32x4*)(conv_b + col), b = *(const f32x4*)(conv_b + col + 4);
#pragma unroll
              for (int i = 0; i < 4; ++i) { bia[i] = a[i]; bia[4 + i] = b[i]; } }
            int hmode;
            int sbat = 0;
            if (pm < 128) hmode = seg > 0 ? 1 : ((pm & 15) == 0 ? 0 : 2);
            else { const int mm0 = (pm - 128) * 256 + seg * 32; if ((mm0 & 63) == 0) { hmode = 3; sbat = mm0 >> 6; } else hmode = 1; }
#pragma unroll
            for (int j = 0; j < 3; ++j) {
                if (hmode == 0) {
#pragma unroll
                    for (int i = 0; i < 8; ++i) hw[j][i] = 0.f;
                } else if (hmode == 3) { const float* p = state_conv + ((size_t)sbat * 3 + j) * CD + col; const f32x4 a = *(const f32x4*)p, b = *(const f32x4*)(p + 4);
#pragma unroll
                    for (int i = 0; i < 4; ++i) { hw[j][i] = a[i]; hw[j][4 + i] = b[i]; }
                } else { const bf16* p = hmode == 1 ? XBC + (size_t)(row0 - 3 + j) * CD + col : HB + ((size_t)(pm - 1) * 3 + j) * CD + col; f32x4 a, b; epi::unpack8(*(const u32x4*)p, a, b);
#pragma unroll
                    for (int i = 0; i < 4; ++i) { hw[j][i] = a[i]; hw[j][4 + i] = b[i]; } }
            }
            asm volatile("s_waitcnt vmcnt(0)" ::: "memory"); __syncthreads();
            float* cout = nullptr; int cfirst = 0;
            if (pm < 128) { if ((pm & 15) == 15 && seg == 7) { cout = out + O_CONV_P + (size_t)(pm >> 4) * 3 * CD + col; cfirst = 29; } }
            else { const int mm0 = (pm - 128) * 256 + seg * 32; if ((mm0 & 63) == 32) { cout = out + O_CONV_S + (size_t)(mm0 >> 6) * 3 * CD + col; cfirst = 29; } }
            for (int rb = 0; rb < 32; rb += 8) {
                u32x4 raw[8];
#pragma unroll
                for (int k = 0; k < 8; ++k) raw[k] = *(const u32x4*)(XBC + (size_t)(row0 + rb + k) * CD + col);
#pragma unroll
                for (int k = 0; k < 8; ++k) { f32x4 a, b; epi::unpack8(raw[k], a, b); float xv[8], o[8];
#pragma unroll
                    for (int i = 0; i < 4; ++i) { xv[i] = a[i]; xv[4 + i] = b[i]; }
                    if (cout && rb + k >= cfirst) { float* cp = cout + (size_t)(rb + k - cfirst) * CD; *(f32x4*)cp = a; *(f32x4*)(cp + 4) = b; }
#pragma unroll
                    for (int i = 0; i < 8; ++i) { const float y = bia[i] + w[0][i] * hw[0][i] + w[1][i] * hw[1][i] + w[2][i] * hw[2][i] + w[3][i] * xv[i]; o[i] = epi::silu(y);
                        hw[0][i] = hw[1][i]; hw[1][i] = hw[2][i]; hw[2][i] = xv[i]; }
                    *(u32x4*)(XBC + (size_t)(row0 + rb + k) * CD + col) = epi::pack8((f32x4){o[0], o[1], o[2], o[3]}, (f32x4){o[4], o[5], o[6], o[7]}); }
            }
            __syncthreads();
        }
        if (BOTH(2)) GRID_BAR();
    }

    if (IN(3)) {
        constexpr int NSSD = 64;
        if (vcu < NSSD) {
            ssd::Task T; T.tok0 = (vcu >> 3) * PL; T.nchunk = PL / 64; T.b = vcu >> 3; T.hgrp = vcu & 7; T.h0 = nullptr; T.hout = out + O_SSM_P + (size_t)(vcu >> 3) * NHS * 64 * DST;
            ssd::run(lds + RING_OFF, T, XBC, DT, a_log, d_skip);
        } else {
            const int w = vcu - NSSD, NW_ = G - NSSD;
            for (int t = w; t < SB_ * 8; t += NW_) {
                ssd::Task T; T.b = t >> 3; T.hgrp = t & 7; T.tok0 = M_P + T.b * SL; T.nchunk = 1; T.h0 = state_ssm + (size_t)T.b * NHS * 64 * DST; T.hout = out + O_SSM_S + (size_t)T.b * NHS * 64 * DST;
                ssd::run(lds + RING_OFF, T, XBC, DT, a_log, d_skip);
            }
            __syncthreads();
            for (int u = w; u < 2048 + 512; u += NW_) {
                att::Unit U;
                if (u < 2048) { U.sample = 0; U.qb = u & 15; U.h = (u >> 4) & 15; U.b = u >> 8; }
                else { const int s = u - 2048; U.sample = 1; U.qb = 0; U.h = s & 15; U.b = s >> 4; }
                att::unit(lds + RING_OFF, U, QB, KB, VB, cache_k, cache_v, rel_bias);
            }
        }
        if (BOTH(3)) GRID_BAR();
    }

    if (IN(4)) {
        pg8::Gemm g{XN, WIN + (size_t)N_A * DM, M, N_C0, DM, DM}; pg8::StaticOrder S; S.init(M, N_C0, G, bx);
        epi::EpiC0 E{XBC, QB, GB, PSQ};
        pg8::gemm_phase<epi::EpiC0, pg8::StaticOrder, true, true>(lds + RING_OFF, g, S, E);
        if (BOTH(4)) GRID_BAR();
    }

    if (IN(5)) {
        for (int m = gw; m < M; m += NGW) {
            const float* ps = PSQ + (size_t)m * 32; float rs[4];
#pragma unroll
            for (int g4 = 0; g4 < 4; ++g4) { const f32x4 a = *(const f32x4*)(ps + g4 * 8), b = *(const f32x4*)(ps + g4 * 8 + 4); rs[g4] = 1.f / sqrtf(((a[0] + a[1]) + (a[2] + a[3]) + (b[0] + b[1]) + (b[2] + b[3])) * (1.f / 512.f) + EPS); }
            bf16* yr = XBC + (size_t)m * CD;
#pragma unroll
            for (int j = 0; j < 4; ++j) { u32x4* p = (u32x4*)(yr + (size_t)(j * 64 + lane) * 8); f32x4 a, b; epi::unpack8(*p, a, b); *p = epi::pack8(a * rs[j], b * rs[j]); }
        }
        if (BOTH(5)) GRID_BAR();
    }

    if (IN(6)) {
        { pg8::Gemm g{XBC, W1T, M, DM, DI, CD}; pg8::StaticOrder S; S.init(M, DM, G, bx); epi::EpiMerge<false> E{GB, MRG};
          pg8::gemm_phase<epi::EpiMerge<false>, pg8::StaticOrder, true, true>(lds + RING_OFF, g, S, E); }
        asm volatile("s_waitcnt vmcnt(0)" ::: "memory"); __syncthreads();
        { pg8::Gemm g{QB, W2T, M, DM, DA, DM}; pg8::StaticOrder S; S.init(M, DM, G, bx); epi::EpiMerge<true> E{GB, MRG};
          pg8::gemm_phase<epi::EpiMerge<true>, pg8::StaticOrder, true, true>(lds + RING_OFF, g, S, E); }
        if (BOTH(6)) GRID_BAR();
    }

    if (IN(7)) {
        pg8::Gemm g{MRG, W3T, M, DM, DM, DM}; pg8::StaticOrder S; S.init(M, DM, G, bx); epi::EpiOut E{x_p, x_s, out};
        pg8::gemm_phase<epi::EpiOut, pg8::StaticOrder, true, true>(lds + RING_OFF, g, S, E);
        if (BOTH(7)) GRID_BAR();
    }

    if (IN(8)) {
        for (int m = gw; m < M; m += NGW) {
            GAS f32x4* xr = (GAS f32x4*)(out + (size_t)m * DM) + lane; f32x4 v[4]; float s2 = 0.f;
#pragma unroll
            for (int j = 0; j < 4; ++j) { v[j] = xr[64 * j]; s2 += (v[j].x * v[j].x + v[j].y * v[j].y) + (v[j].z * v[j].z + v[j].w * v[j].w); }
            const float rstd = 1.f / sqrtf(wave_sum(s2) * (1.f / DM) + EPS);
#pragma unroll
            for (int j = 0; j < 4; ++j) { const f32x4 w = *((const f32x4*)final_norm_w + 64 * j + lane); xr[64 * j] = v[j] * rstd * w; }
        }
    }
#undef IN
#undef BOTH
#undef GRID_BAR
}

extern "C" void kernel_launch(void* const* d_in, const int* in_sizes, int n_in, void* d_out, int out_size, void* d_ws, size_t ws_size, hipStream_t stream) {
    static int grid = 0;
    if (grid == 0) {
        if (n_in != 19 || in_sizes[0] != M_P * DM || (size_t)out_size != O_END || ws_size < WS_END) { fprintf(stderr, "kernel_launch: unexpected shapes (n_in %d, in0 %d, out %d, ws %zu); nothing launched\n", n_in, n_in > 0 ? in_sizes[0] : -1, out_size, ws_size); grid = -1; return; }
        int dev = 0, cus = 0, per_cu = 0;
        if (hipGetDevice(&dev) != hipSuccess || hipDeviceGetAttribute(&cus, hipDeviceAttributeMultiprocessorCount, dev) != hipSuccess) { grid = -1; return; }
        if (hipFuncSetAttribute((const void*)mk_fwd, hipFuncAttributeMaxDynamicSharedMemorySize, LDS_BYTES) != hipSuccess) { fprintf(stderr, "kernel_launch: hipFuncSetAttribute failed\n"); grid = -1; return; }
        if (hipOccupancyMaxActiveBlocksPerMultiprocessor(&per_cu, (const void*)mk_fwd, NWAVES * 64, LDS_BYTES) != hipSuccess || per_cu < 1) fprintf(stderr, "kernel_launch: occupancy query reports %d\n", per_cu);
        (void)hipGetLastError();
        grid = cus;
    }
    if (grid < 0) return;
    if (hipMemsetAsync((char*)d_ws + WS_CTL, 0, CTL_ZERO_BYTES, stream) != hipSuccess) { fprintf(stderr, "kernel_launch: memset failed\n"); return; }
    Args a{};
    for (int i = 0; i < 19; ++i) a.in[i] = (const float*)d_in[i];
    a.out = (float*)d_out; a.ws = (unsigned char*)d_ws;
    for (int li = 0; li < N_LAUNCHES; ++li) {
        if (N_LAUNCHES == 1) { a.ph_lo = 0; a.ph_hi = N_PHASES; } else { a.ph_lo = li * N_PHASES / N_LAUNCHES; a.ph_hi = (li + 1) * N_PHASES / N_LAUNCHES; }
        a.li = li;
        hipLaunchKernelGGL(mk_fwd, dim3(grid), dim3(NWAVES * 64), LDS_BYTES, stream, a);
        const hipError_t le = hipPeekAtLastError();
        if (le != hipSuccess) { fprintf(stderr, "kernel_launch: launch %d failed: %s\n", li, hipGetErrorName(le)); break; }
    }
}
```
